# Optimizing an MI355X kernel written in HIP

```python
import math
import jax, jax.numpy as jnp
from jax import lax
import numpy as np

D_MODEL = 1024
BATCH = 1
SEQ = 16384
DEPTH = 1

D_MIX = D_MODEL
D_ATTN = D_MIX // 2
D_POOL = D_MIX - D_ATTN
HEAD_DIM = 64
N_Q_HEADS = D_ATTN // HEAD_DIM
N_KV_HEADS = 2
Q_PER_KV = N_Q_HEADS // N_KV_HEADS
D_KV = N_KV_HEADS * HEAD_DIM
WINDOW = 128
BLOCK = 128
N_BUCKETS = 32
MAX_DISTANCE = 128
POOL_WINDOWS = (2, 4, 8, 16)
N_POOL_GROUPS = len(POOL_WINDOWS)
POOL_GROUP = D_POOL // N_POOL_GROUPS
D_IN = 2 * D_ATTN + 2 * D_KV + 2 * D_POOL
EPS = 1e-6
NEG = -1e30

kernel_name = "hymba_bidir_swa_pool_hybrid"


def rmsnorm(x, g):
    xf = x.astype(jnp.float32)
    y = xf * lax.rsqrt(jnp.mean(xf * xf, axis=-1, keepdims=True) + EPS)
    return (y * g.astype(jnp.float32)).astype(x.dtype)


def t5_bucket(rel):
    nb = N_BUCKETS // 2
    max_exact = nb // 2
    ret = jnp.where(rel > 0, nb, 0)
    n = jnp.abs(rel)
    nf = jnp.maximum(n, 1).astype(jnp.float32)
    large = max_exact + (jnp.log(nf / max_exact) / math.log(MAX_DISTANCE / max_exact)
                         * (nb - max_exact)).astype(jnp.int32)
    large = jnp.minimum(large, nb - 1)
    return ret + jnp.where(n < max_exact, n, large)


def banded_attention(q, k, v, rel_bias, sink):
    B, S = q.shape[0], q.shape[1]
    nb = S // BLOCK
    qb = q.reshape(B, nb, BLOCK, N_KV_HEADS, Q_PER_KV, HEAD_DIM)
    pad = ((0, 0), (BLOCK, BLOCK), (0, 0), (0, 0))
    kp = jnp.pad(k, pad).reshape(B, nb + 2, BLOCK, N_KV_HEADS, HEAD_DIM)
    vp = jnp.pad(v, pad).reshape(B, nb + 2, BLOCK, N_KV_HEADS, HEAD_DIM)
    kw = jnp.concatenate([kp[:, :-2], kp[:, 1:-1], kp[:, 2:]], axis=2)
    vw = jnp.concatenate([vp[:, :-2], vp[:, 1:-1], vp[:, 2:]], axis=2)

    scale = HEAD_DIM ** -0.5
    s = jnp.einsum('bnqkgd,bnskd->bnkgqs', qb, kw).astype(jnp.float32) * scale

    qi = jnp.arange(BLOCK)[:, None]
    kj = jnp.arange(3 * BLOCK)[None, :]
    rel = (kj - BLOCK) - qi
    bias = rel_bias.astype(jnp.float32)[t5_bucket(rel)]
    bias = jnp.transpose(bias, (2, 0, 1)).reshape(N_KV_HEADS, Q_PER_KV, BLOCK, 3 * BLOCK)
    key_pos = jnp.arange(nb)[:, None] * BLOCK - BLOCK + jnp.arange(3 * BLOCK)[None, :]
    valid = (jnp.abs(rel) <= WINDOW)[None] & ((key_pos >= 0) & (key_pos < S))[:, None, :]
    s = jnp.where(valid[None, :, None, None], s + bias[None, None], NEG)

    sk = sink.astype(jnp.float32).reshape(1, 1, N_KV_HEADS, Q_PER_KV, 1, 1)
    m = jnp.maximum(jnp.max(s, axis=-1, keepdims=True), sk)
    p = jnp.exp(s - m)
    p = p / (jnp.sum(p, axis=-1, keepdims=True) + jnp.exp(sk - m))
    o = jnp.einsum('bnkgqs,bnskd->bnqkgd', p.astype(v.dtype), vw)
    return o.reshape(B, S, N_Q_HEADS * HEAD_DIM)


def multiscale_pool(u, pool_w, pool_scale):
    B, S, _ = u.shape
    uf = u.astype(jnp.float32)
    c = jnp.concatenate([jnp.zeros((B, 1, D_POOL), jnp.float32), jnp.cumsum(uf, axis=1)], axis=1)
    t = jnp.arange(S)
    outs = []
    for gi, w in enumerate(POOL_WINDOWS):
        left = w // 2
        right = w - 1 - left
        lo = jnp.maximum(t - left, 0)
        hi = jnp.minimum(t + right + 1, S)
        sl = slice(gi * POOL_GROUP, (gi + 1) * POOL_GROUP)
        cg = c[..., sl]
        mean = (cg[:, hi] - cg[:, lo]) / (hi - lo).astype(jnp.float32)[None, :, None]
        outs.append(mean - uf[..., sl])
    y = jnp.stack(outs, axis=2)
    y = jnp.einsum('bsgc,gcd->bsgd', y, pool_w.astype(jnp.float32)).reshape(B, S, D_POOL)
    return (y * pool_scale.astype(jnp.float32)).astype(u.dtype)


def setup_inputs(seed: int = 0) -> dict:
    key = jax.random.key(seed)
    ks = jax.random.split(key, 10)
    f32 = jnp.float32
    x = jax.random.normal(ks[0], (BATCH, SEQ, D_MODEL), f32)
    pre_norm_g = 1.0 + 0.05 * jax.random.normal(ks[1], (DEPTH, D_MODEL), f32)
    w_in = jax.random.normal(ks[2], (DEPTH, D_MODEL, D_IN), f32) * D_MODEL ** -0.5
    rel_bias = 0.5 * jax.random.normal(ks[3], (N_BUCKETS, N_Q_HEADS), f32)
    attn_sink = 0.5 * jax.random.normal(ks[4], (DEPTH, N_Q_HEADS), f32)
    pool_w = jax.random.normal(ks[5], (DEPTH, N_POOL_GROUPS, POOL_GROUP, POOL_GROUP), f32) * POOL_GROUP ** -0.5
    pool_scale = 1.0 + 0.1 * jax.random.normal(ks[6], (DEPTH, D_POOL), f32)
    w_out = jax.random.normal(ks[7], (DEPTH, D_MIX, D_MODEL), f32) * D_MIX ** -0.5
    post_norm_g = 1.0 + 0.05 * jax.random.normal(ks[8], (DEPTH, D_MODEL), f32)
    return {"x": x, "pre_norm_g": pre_norm_g, "w_in": w_in, "rel_bias": rel_bias,
            "attn_sink": attn_sink, "pool_w": pool_w, "pool_scale": pool_scale,
            "w_out": w_out, "post_norm_g": post_norm_g}


def reference(x, pre_norm_g, w_in, rel_bias, attn_sink, pool_w, pool_scale, w_out, post_norm_g):
    B, S, _ = x.shape
    splits = [D_ATTN, D_ATTN + D_KV, D_ATTN + 2 * D_KV,
              2 * D_ATTN + 2 * D_KV, 2 * D_ATTN + 2 * D_KV + D_POOL]
    for l in range(DEPTH):
        h = rmsnorm(x, pre_norm_g[l])
        proj = jnp.einsum('bsd,de->bse', h, w_in[l])
        q, k, v, g_a, u_p, g_p = jnp.split(proj, splits, axis=-1)
        q = q.reshape(B, S, N_Q_HEADS, HEAD_DIM)
        k = k.reshape(B, S, N_KV_HEADS, HEAD_DIM)
        v = v.reshape(B, S, N_KV_HEADS, HEAD_DIM)
        a = banded_attention(q, k, v, rel_bias, attn_sink[l]) * jax.nn.silu(g_a)
        p = multiscale_pool(u_p, pool_w[l], pool_scale[l]) * jax.nn.silu(g_p)
        mixed = jnp.einsum('bse,ed->bsd', jnp.concatenate([a, p], axis=-1), w_out[l])
        x = x + rmsnorm(mixed, post_norm_g[l])
    return x
```

```cpp
#include <hip/hip_runtime.h>
#include <cstdio>
#include <cstdint>

constexpr int S = 16384, DM = 1024, DIN = 2304, DATT = 512, DKV = 128, DPOOL = 512, HD = 64, NQH = 8, NKVH = 2;
constexpr int COL_Q = 0, COL_K = 512, COL_V = 640, COL_GA = 768, COL_UP = 1280, COL_GP = 1792;
constexpr float EPS = 1e-6f;

typedef unsigned short bf16;
typedef short bf16x8 __attribute__((ext_vector_type(8)));
typedef float f32x4 __attribute__((ext_vector_type(4)));
typedef unsigned u32x4 __attribute__((ext_vector_type(4)));

__device__ __forceinline__ unsigned f2bf(float f) { unsigned u = __builtin_bit_cast(unsigned, f); return (u + 0x7fffu + ((u >> 16) & 1u)) >> 16; }
__device__ __forceinline__ float bf2f(unsigned h) { return __builtin_bit_cast(float, h << 16); }
__device__ __forceinline__ unsigned pk2(float lo, float hi) { return f2bf(lo) | (f2bf(hi) << 16); }

constexpr size_t MiB = 1u << 20;
constexpr size_t WS_WIN = 2 * MiB, WS_WOUT = 8 * MiB, WS_PW = 10 * MiB, WS_XN = 16 * MiB, WS_PROJ = 48 * MiB, WS_MIX = 120 * MiB, WS_MIXED = 152 * MiB;

__global__ void __launch_bounds__(256) k_transpose(const float* __restrict__ W, int K, int N, bf16* __restrict__ WT) {
    __shared__ float t[32][33];
    const int k0 = blockIdx.y * 32, n0 = blockIdx.x * 32, tx = threadIdx.x & 31, ty = threadIdx.x >> 5;
    for (int i = ty; i < 32; i += 8) t[i][tx] = W[(size_t)(k0 + i) * N + n0 + tx];
    __syncthreads();
    for (int i = ty; i < 32; i += 8) WT[(size_t)(n0 + i) * K + k0 + tx] = (bf16)f2bf(t[tx][i]);
}
__global__ void __launch_bounds__(256) k_prenorm(const float* __restrict__ x, const float* __restrict__ g, bf16* __restrict__ xn) {
    const int row = blockIdx.x * 4 + (threadIdx.x >> 6), lane = threadIdx.x & 63;
    const f32x4* xr = (const f32x4*)(x + (size_t)row * DM);
    f32x4 v[4]; float s = 0.f;
#pragma unroll
    for (int j = 0; j < 4; ++j) { v[j] = xr[lane + 64 * j]; s += v[j].x * v[j].x + v[j].y * v[j].y + v[j].z * v[j].z + v[j].w * v[j].w; }
#pragma unroll
    for (int o = 1; o < 64; o <<= 1) s += __shfl_xor(s, o);
    const float r = rsqrtf(s * (1.f / DM) + EPS);
#pragma unroll
    for (int j = 0; j < 4; ++j) {
        const f32x4 gg = ((const f32x4*)g)[lane + 64 * j];
        uint2 o; o.x = pk2(v[j].x * r * gg.x, v[j].y * r * gg.y); o.y = pk2(v[j].z * r * gg.z, v[j].w * r * gg.w);
        ((uint2*)(xn + (size_t)row * DM))[lane + 64 * j] = o;
    }
}
template <bool OUT_BF16>
__global__ void __launch_bounds__(256) k_gemm(const bf16* __restrict__ A, const bf16* __restrict__ Bt, void* __restrict__ Cv, int M, int N, int K) {
    __shared__ __attribute__((aligned(16))) bf16 sA[128][40];
    __shared__ __attribute__((aligned(16))) bf16 sB[128][40];
    const int tid = threadIdx.x, wid = tid >> 6, lane = tid & 63, wr = wid >> 1, wc = wid & 1, fr = lane & 15, fq = lane >> 4;
    const int brow = blockIdx.y * 128, bcol = blockIdx.x * 128;
    f32x4 acc[4][4];
#pragma unroll
    for (int m = 0; m < 4; ++m)
#pragma unroll
        for (int n = 0; n < 4; ++n) acc[m][n] = (f32x4){0.f, 0.f, 0.f, 0.f};
    for (int k0 = 0; k0 < K; k0 += 32) {
#pragma unroll
        for (int i = 0; i < 2; ++i) {
            const int e = tid + i * 256, r = e >> 2, c = (e & 3) * 8;
            *(u32x4*)&sA[r][c] = *(const u32x4*)(A + (size_t)(brow + r) * K + k0 + c);
            *(u32x4*)&sB[r][c] = *(const u32x4*)(Bt + (size_t)(bcol + r) * K + k0 + c);
        }
        __syncthreads();
        bf16x8 a[4], b[4];
#pragma unroll
        for (int m = 0; m < 4; ++m) a[m] = *(const bf16x8*)&sA[wr * 64 + m * 16 + fr][fq * 8];
#pragma unroll
        for (int n = 0; n < 4; ++n) b[n] = *(const bf16x8*)&sB[wc * 64 + n * 16 + fr][fq * 8];
#pragma unroll
        for (int m = 0; m < 4; ++m)
#pragma unroll
            for (int n = 0; n < 4; ++n) acc[m][n] = __builtin_amdgcn_mfma_f32_16x16x32_bf16(a[m], b[n], acc[m][n], 0, 0, 0);
        __syncthreads();
    }
#pragma unroll
    for (int m = 0; m < 4; ++m)
#pragma unroll
        for (int n = 0; n < 4; ++n)
#pragma unroll
            for (int j = 0; j < 4; ++j) {
                const size_t r = brow + wr * 64 + m * 16 + fq * 4 + j, c = bcol + wc * 64 + n * 16 + fr;
                if (OUT_BF16) ((bf16*)Cv)[r * N + c] = (bf16)f2bf(acc[m][n][j]); else ((float*)Cv)[r * N + c] = acc[m][n][j];
            }
}
__device__ __forceinline__ int t5_bucket(int rel) {
    const int n = rel < 0 ? -rel : rel;
    int b = n;
    if (n >= 8) b = n >= 91 ? 15 : n >= 64 ? 14 : n >= 46 ? 13 : n >= 32 ? 12 : n >= 23 ? 11 : n >= 16 ? 10 : n >= 12 ? 9 : 8;
    return b + (rel > 0 ? 16 : 0);
}
__global__ void __launch_bounds__(256) k_attn(const bf16* __restrict__ proj, const float* __restrict__ rel_bias, const float* __restrict__ sink, bf16* __restrict__ mix) {
    __shared__ float sb[257];
    const int h = blockIdx.y, i = blockIdx.x * 256 + threadIdx.x, kvh = h >> 2;
    for (int r = threadIdx.x; r < 257; r += 256) sb[r] = rel_bias[t5_bucket(r - 128) * NQH + h];
    __syncthreads();
    float q[64], o[64];
    const bf16* qp = proj + (size_t)i * DIN + COL_Q + h * HD;
#pragma unroll
    for (int d = 0; d < 64; d += 8) { const u32x4 w = *(const u32x4*)(qp + d);
#pragma unroll
        for (int e = 0; e < 4; ++e) { q[d + 2 * e] = bf2f(w[e] & 0xffffu) * 0.125f; q[d + 2 * e + 1] = bf2f(w[e] >> 16) * 0.125f; } }
#pragma unroll
    for (int d = 0; d < 64; ++d) o[d] = 0.f;
    float m = sink[h], l = 0.f;
    const int jlo = i - 128 < 0 ? 0 : i - 128, jhi = i + 128 > S - 1 ? S - 1 : i + 128;
    for (int j = jlo; j <= jhi; ++j) {
        const bf16* kp = proj + (size_t)j * DIN + COL_K + kvh * HD;
        float s = 0.f;
#pragma unroll
        for (int d = 0; d < 64; d += 8) { const u32x4 w = *(const u32x4*)(kp + d);
#pragma unroll
            for (int e = 0; e < 4; ++e) { s += q[d + 2 * e] * bf2f(w[e] & 0xffffu); s += q[d + 2 * e + 1] * bf2f(w[e] >> 16); } }
        s += sb[j - i + 128];
        if (s > m) { const float sc = __expf(m - s); l *= sc;
#pragma unroll
            for (int d = 0; d < 64; ++d) o[d] *= sc;
            m = s; }
        const float p = __expf(s - m); l += p;
        const bf16* vp = proj + (size_t)j * DIN + COL_V + kvh * HD;
#pragma unroll
        for (int d = 0; d < 64; d += 8) { const u32x4 w = *(const u32x4*)(vp + d);
#pragma unroll
            for (int e = 0; e < 4; ++e) { o[d + 2 * e] += p * bf2f(w[e] & 0xffffu); o[d + 2 * e + 1] += p * bf2f(w[e] >> 16); } }
    }
    l += __expf(sink[h] - m);
    const float il = 1.f / l;
    const bf16* gp = proj + (size_t)i * DIN + COL_GA + h * HD;
    bf16* op = mix + (size_t)i * DM + h * HD;
#pragma unroll
    for (int d = 0; d < 64; d += 2) {
        const unsigned w = *(const unsigned*)(gp + d);
        const float g0 = bf2f(w & 0xffffu), g1 = bf2f(w >> 16);
        const float a0 = o[d] * il * (g0 / (1.f + __expf(-g0))), a1 = o[d + 1] * il * (g1 / (1.f + __expf(-g1)));
        *(unsigned*)(op + d) = pk2(a0, a1);
    }
}
__global__ void __launch_bounds__(256) k_pool(const bf16* __restrict__ proj, const float* __restrict__ pool_w, const float* __restrict__ pool_scale, bf16* __restrict__ mix) {
    __shared__ float y[32][129];
    const int g = blockIdx.y, t0 = blockIdx.x * 32, tid = threadIdx.x;
    const int w = 2 << g, left = w / 2, right = w - 1 - left;
    for (int e = tid; e < 32 * 128; e += 256) {
        const int tt = e >> 7, c = e & 127, t = t0 + tt;
        const int lo = t - left < 0 ? 0 : t - left, hi = t + right + 1 > S ? S : t + right + 1;
        float s = 0.f;
        for (int j = lo; j < hi; ++j) s += bf2f(proj[(size_t)j * DIN + COL_UP + g * 128 + c]);
        y[tt][c] = s / (float)(hi - lo) - bf2f(proj[(size_t)t * DIN + COL_UP + g * 128 + c]);
    }
    __syncthreads();
    const int tt = tid >> 3, d0 = (tid & 7) * 16, t = t0 + tt;
    float acc[16];
#pragma unroll
    for (int d = 0; d < 16; ++d) acc[d] = 0.f;
    for (int c = 0; c < 128; ++c) { const float yv = y[tt][c]; const float* pw = pool_w + ((size_t)g * 128 + c) * 128 + d0;
#pragma unroll
        for (int d = 0; d < 16; ++d) acc[d] += yv * pw[d]; }
#pragma unroll
    for (int d = 0; d < 16; ++d) {
        const float gp = bf2f(proj[(size_t)t * DIN + COL_GP + g * 128 + d0 + d]);
        const float p = acc[d] * pool_scale[g * 128 + d0 + d] * (gp / (1.f + __expf(-gp)));
        mix[(size_t)t * DM + DATT + g * 128 + d0 + d] = (bf16)f2bf(p);
    }
}
__global__ void __launch_bounds__(256) k_postnorm(const float* __restrict__ x, const float* __restrict__ mixed, const float* __restrict__ g, float* __restrict__ out) {
    const int row = blockIdx.x * 4 + (threadIdx.x >> 6), lane = threadIdx.x & 63;
    const f32x4* mr = (const f32x4*)(mixed + (size_t)row * DM);
    const f32x4* xr = (const f32x4*)(x + (size_t)row * DM);
    f32x4 v[4]; float s = 0.f;
#pragma unroll
    for (int j = 0; j < 4; ++j) { v[j] = mr[lane + 64 * j]; s += v[j].x * v[j].x + v[j].y * v[j].y + v[j].z * v[j].z + v[j].w * v[j].w; }
#pragma unroll
    for (int o = 1; o < 64; o <<= 1) s += __shfl_xor(s, o);
    const float r = rsqrtf(s * (1.f / DM) + EPS);
#pragma unroll
    for (int j = 0; j < 4; ++j) {
        const f32x4 gg = ((const f32x4*)g)[lane + 64 * j], xx = xr[lane + 64 * j];
        ((f32x4*)(out + (size_t)row * DM))[lane + 64 * j] = xx + v[j] * r * gg;
    }
}

extern "C" void kernel_launch(void* const* d_in, const int* in_sizes, int n_in, void* d_out, int out_size, void* d_ws, size_t ws_size, hipStream_t stream) {
    const float* x = (const float*)d_in[0]; const float* pre_g = (const float*)d_in[1]; const float* w_in = (const float*)d_in[2];
    const float* rel_bias = (const float*)d_in[3]; const float* sink = (const float*)d_in[4]; const float* pool_w = (const float*)d_in[5];
    const float* pool_scale = (const float*)d_in[6]; const float* w_out = (const float*)d_in[7]; const float* post_g = (const float*)d_in[8];
    unsigned char* ws = (unsigned char*)d_ws;
    bf16* WinT = (bf16*)(ws + WS_WIN); bf16* WoutT = (bf16*)(ws + WS_WOUT); bf16* XN = (bf16*)(ws + WS_XN); bf16* PROJ = (bf16*)(ws + WS_PROJ);
    bf16* MIX = (bf16*)(ws + WS_MIX); float* MIXED = (float*)(ws + WS_MIXED);
    hipLaunchKernelGGL(k_transpose, dim3(DIN / 32, DM / 32), dim3(256), 0, stream, w_in, DM, DIN, WinT);
    hipLaunchKernelGGL(k_transpose, dim3(DM / 32, DM / 32), dim3(256), 0, stream, w_out, DM, DM, WoutT);
    hipLaunchKernelGGL(k_prenorm, dim3(S / 4), dim3(256), 0, stream, x, pre_g, XN);
    hipLaunchKernelGGL(k_gemm<true>, dim3(DIN / 128, S / 128), dim3(256), 0, stream, XN, WinT, (void*)PROJ, S, DIN, DM);
    hipLaunchKernelGGL(k_attn, dim3(S / 256, NQH), dim3(256), 0, stream, PROJ, rel_bias, sink, MIX);
    hipLaunchKernelGGL(k_pool, dim3(S / 32, 4), dim3(256), 0, stream, PROJ, pool_w, pool_scale, MIX);
    hipLaunchKernelGGL(k_gemm<false>, dim3(DM / 128, S / 128), dim3(256), 0, stream, MIX, WoutT, (void*)MIXED, S, DM, DM);
    hipLaunchKernelGGL(k_postnorm, dim3(S / 4), dim3(256), 0, stream, x, MIXED, post_g, (float*)d_out);
}
```
